# Optimizing an MI355X kernel written in HIP

```python
import jax, jax.numpy as jnp
from jax import lax
import numpy as np


D_MODEL = 1024
BATCH = 8
SEQ = 2048
DEPTH = 1

MOBA_WIDTH = D_MODEL // 2
MOBA_HEAD_DIM = 64
MOBA_HEADS = MOBA_WIDTH // MOBA_HEAD_DIM
MOBA_BLOCK = 256
MOBA_TOPK = 3
MOBA_QUERY_CHUNK = 32

GLA_HEADS = 4
GLA_V_WIDTH = D_MODEL - MOBA_WIDTH
GLA_VALUE_DIM = GLA_V_WIDTH // GLA_HEADS
GLA_KEY_DIM = GLA_VALUE_DIM // 2
GLA_K_WIDTH = GLA_HEADS * GLA_KEY_DIM
GLA_GATE_RANK = 16
GLA_GATE_TAU = 16.0
GLA_CHUNK = 64

MIX_WIDTH = MOBA_WIDTH + GLA_V_WIDTH
D_FF = 2816
RMS_EPS = 1e-6

IN_PARTS = (MOBA_WIDTH, MOBA_WIDTH, MOBA_WIDTH,
            GLA_K_WIDTH, GLA_K_WIDTH, GLA_V_WIDTH,
            GLA_GATE_RANK, GLA_V_WIDTH)
IN_WIDTH = sum(IN_PARTS)
IN_SPLITS = tuple(int(v) for v in np.cumsum(IN_PARTS)[:-1])

kernel_name = 'hybrid_moba_gla_macaron'


def rms_norm(x, g):
    xf = x.astype(jnp.float32)
    y = xf * lax.rsqrt(jnp.mean(xf * xf, axis=-1, keepdims=True) + RMS_EPS)
    return (y * g.astype(jnp.float32)).astype(x.dtype)


def swiglu(x, w_gate, w_up, w_down):
    return (jax.nn.silu(x @ w_gate) * (x @ w_up)) @ w_down


def split_heads(t, n_heads):
    b, s, _ = t.shape
    return t.reshape(b, s, n_heads, -1).transpose(0, 2, 1, 3)


def moba_attention(q, k, v):
    B, H, S, dh = q.shape
    n_blk = -(-S // MOBA_BLOCK)
    Lp = n_blk * MOBA_BLOCK
    pad = ((0, 0), (0, 0), (0, Lp - S), (0, 0))
    q, k, v = jnp.pad(q, pad), jnp.pad(k, pad), jnp.pad(v, pad)
    kb = k.reshape(B, H, n_blk, MOBA_BLOCK, dh)
    vb = v.reshape(B, H, n_blk, MOBA_BLOCK, dh)
    k_mean = jnp.mean(kb.astype(jnp.float32), axis=3).astype(k.dtype)
    n_sel = min(MOBA_TOPK, n_blk)
    scale = dh ** -0.5
    bi = jnp.arange(B)[:, None, None, None]
    hi = jnp.arange(H)[None, :, None, None]
    blk_ids = jnp.arange(n_blk)
    key_off = jnp.arange(MOBA_BLOCK)
    q_off = jnp.arange(MOBA_QUERY_CHUNK)
    QC = MOBA_QUERY_CHUNK

    def chunk(c):
        start = c * QC
        blk = start // MOBA_BLOCK
        qc = lax.dynamic_slice_in_dim(q, start, QC, axis=2)
        gate = jnp.einsum('bhqd,bhnd->bhqn', qc, k_mean).astype(jnp.float32)
        gate = jnp.where(blk_ids < blk, gate, -jnp.inf)
        _, sel = lax.top_k(gate, n_sel)
        valid = sel < blk
        k_sel = kb[bi, hi, sel]
        v_sel = vb[bi, hi, sel]
        s_sel = jnp.einsum('bhqd,bhqnld->bhqnl', qc, k_sel).astype(jnp.float32) * scale
        s_sel = jnp.where(valid[..., None], s_sel, -jnp.inf).reshape(B, H, QC, n_sel * MOBA_BLOCK)
        k_own = lax.dynamic_index_in_dim(kb, blk, axis=2, keepdims=False)
        v_own = lax.dynamic_index_in_dim(vb, blk, axis=2, keepdims=False)
        s_own = jnp.einsum('bhqd,bhld->bhql', qc, k_own).astype(jnp.float32) * scale
        causal = (blk * MOBA_BLOCK + key_off)[None, :] <= (start + q_off)[:, None]
        s_own = jnp.where(causal, s_own, -jnp.inf)
        p = jax.nn.softmax(jnp.concatenate([s_own, s_sel], axis=-1), axis=-1).astype(v.dtype)
        p_own = p[..., :MOBA_BLOCK]
        p_sel = p[..., MOBA_BLOCK:].reshape(B, H, QC, n_sel, MOBA_BLOCK)
        return (jnp.einsum('bhql,bhld->bhqd', p_own, v_own)
                + jnp.einsum('bhqnl,bhqnld->bhqd', p_sel, v_sel))

    outs = lax.map(chunk, jnp.arange(Lp // QC))
    out = jnp.moveaxis(outs, 0, 2).reshape(B, H, Lp, dh)
    return out[:, :, :S]


def gla_attention(q, k, v, log_alpha):
    B, H, S, dk = q.shape
    dv = v.shape[-1]
    C = GLA_CHUNK
    n_c = S // C

    def to_chunks(t):
        return jnp.moveaxis(t.reshape(B, H, n_c, C, t.shape[-1]), 2, 0)

    q = q * (dk ** -0.5)
    causal = jnp.tril(jnp.ones((C, C), dtype=bool))[:, :, None]

    def step(state, inp):
        qc, kc, vc, gc = inp
        qf, kf, vf = qc.astype(jnp.float32), kc.astype(jnp.float32), vc.astype(jnp.float32)
        b = jnp.cumsum(gc.astype(jnp.float32), axis=2)
        o_inter = jnp.einsum('bhtd,bhde->bhte', qf * jnp.exp(b), state)
        diff = b[:, :, :, None, :] - b[:, :, None, :, :]
        decay = jnp.exp(jnp.where(causal, diff, -jnp.inf))
        a = jnp.einsum('bhtd,bhsd,bhtsd->bhts', qf, kf, decay)
        o_intra = jnp.einsum('bhts,bhse->bhte', a, vf)
        b_last = b[:, :, -1:, :]
        state = (jnp.exp(b_last[:, :, 0, :])[..., None] * state
                 + jnp.einsum('bhsd,bhse->bhde', kf * jnp.exp(b_last - b), vf))
        return state, (o_inter + o_intra).astype(v.dtype)

    state0 = jnp.zeros((B, H, dk, dv), jnp.float32)
    _, o = lax.scan(step, state0, (to_chunks(q), to_chunks(k), to_chunks(v), to_chunks(log_alpha)))
    return jnp.moveaxis(o, 0, 2).reshape(B, H, S, dv)


def setup_inputs(seed: int = 0) -> dict:
    key = jax.random.key(seed)
    ks = jax.random.split(key, 20)
    f32 = jnp.float32

    def w(k, shape, fan_in):
        return jax.random.normal(k, shape, f32) * (fan_in ** -0.5)

    def gain(k, shape):
        return 1.0 + 0.02 * jax.random.normal(k, shape, f32)

    L = DEPTH
    return {
        'x': jax.random.normal(ks[0], (BATCH, SEQ, D_MODEL), f32),
        'ffn1_pre_g': gain(ks[1], (L, D_MODEL)),
        'ffn1_w_gate': w(ks[2], (L, D_MODEL, D_FF), D_MODEL),
        'ffn1_w_up': w(ks[3], (L, D_MODEL, D_FF), D_MODEL),
        'ffn1_w_down': w(ks[4], (L, D_FF, D_MODEL), D_FF),
        'ffn1_post_g': gain(ks[5], (L, D_MODEL)),
        'mix_pre_g': gain(ks[6], (L, D_MODEL)),
        'w_in': w(ks[7], (L, D_MODEL, IN_WIDTH), D_MODEL),
        'gla_w_alpha_up': w(ks[8], (L, GLA_GATE_RANK, GLA_K_WIDTH), GLA_GATE_RANK),
        'gla_b_alpha': 0.01 * jax.random.normal(ks[9], (L, GLA_K_WIDTH), f32),
        'moba_out_g': gain(ks[10], (L, MOBA_WIDTH)),
        'gla_out_g': gain(ks[11], (L, GLA_HEADS, GLA_VALUE_DIM)),
        'w_out': w(ks[12], (L, MIX_WIDTH, D_MODEL), MIX_WIDTH),
        'mix_post_g': gain(ks[13], (L, D_MODEL)),
        'ffn2_pre_g': gain(ks[14], (L, D_MODEL)),
        'ffn2_w_gate': w(ks[15], (L, D_MODEL, D_FF), D_MODEL),
        'ffn2_w_up': w(ks[16], (L, D_MODEL, D_FF), D_MODEL),
        'ffn2_w_down': w(ks[17], (L, D_FF, D_MODEL), D_FF),
        'ffn2_post_g': gain(ks[18], (L, D_MODEL)),
    }


def reference(x, ffn1_pre_g, ffn1_w_gate, ffn1_w_up, ffn1_w_down, ffn1_post_g,
              mix_pre_g, w_in, gla_w_alpha_up, gla_b_alpha, moba_out_g, gla_out_g,
              w_out, mix_post_g, ffn2_pre_g, ffn2_w_gate, ffn2_w_up, ffn2_w_down,
              ffn2_post_g):
    B, S, _ = x.shape
    for l in range(DEPTH):
        f = swiglu(rms_norm(x, ffn1_pre_g[l]), ffn1_w_gate[l], ffn1_w_up[l], ffn1_w_down[l])
        x = x + 0.5 * rms_norm(f, ffn1_post_g[l])

        h = rms_norm(x, mix_pre_g[l])
        proj = h @ w_in[l]
        mq, mk, mv, gq, gk, gv, ga, gr = jnp.split(proj, IN_SPLITS, axis=-1)

        o_moba = moba_attention(split_heads(mq, MOBA_HEADS), split_heads(mk, MOBA_HEADS),
                                split_heads(mv, MOBA_HEADS))
        o_moba = o_moba.transpose(0, 2, 1, 3).reshape(B, S, MOBA_WIDTH)
        o_moba = rms_norm(o_moba, moba_out_g[l])

        z = (ga @ gla_w_alpha_up[l] + gla_b_alpha[l]).astype(jnp.float32)
        log_alpha = jax.nn.log_sigmoid(z) / GLA_GATE_TAU
        o_gla = gla_attention(split_heads(gq, GLA_HEADS), split_heads(gk, GLA_HEADS),
                              split_heads(gv, GLA_HEADS), split_heads(log_alpha, GLA_HEADS))
        o_gla = rms_norm(o_gla.transpose(0, 2, 1, 3), gla_out_g[l])
        o_gla = o_gla.reshape(B, S, GLA_V_WIDTH) * jax.nn.silu(gr)

        mix = jnp.concatenate([o_moba, o_gla], axis=-1) @ w_out[l]
        x = x + rms_norm(mix, mix_post_g[l])

        f = swiglu(rms_norm(x, ffn2_pre_g[l]), ffn2_w_gate[l], ffn2_w_up[l], ffn2_w_down[l])
        x = x + 0.5 * rms_norm(f, ffn2_post_g[l])
    return x
```

```cpp
#include <hip/hip_runtime.h>
#include <cstdio>
#include <cstdint>

constexpr int D_MODEL = 1024, BATCH = 8, SEQ = 2048;
constexpr int MOBA_W = 512, MOBA_DH = 64, MOBA_H = 8, MOBA_BLK = 256, MOBA_TOPK = 3, NBLK = SEQ / MOBA_BLK;
constexpr int GLA_H = 4, GLA_DV = 128, GLA_DK = 64, GLA_KW = 256, GLA_VW = 512, GLA_RANK = 16;
constexpr int D_FF = 2816, IN_W = 3088;
constexpr float RMS_EPS = 1e-6f;
constexpr int C_MQ = 0, C_MK = 512, C_MV = 1024, C_GQ = 1536, C_GK = 1792, C_GV = 2048, C_GA = 2560, C_GR = 2576;

__device__ __forceinline__ float block_sum_256(float v, float* red) {
    for (int o = 32; o > 0; o >>= 1) v += __shfl_xor(v, o);
    const int w = threadIdx.x >> 6;
    __syncthreads();
    if ((threadIdx.x & 63) == 0) red[w] = v;
    __syncthreads();
    float s = red[0] + red[1] + red[2] + red[3];
    return s;
}

__global__ void __launch_bounds__(256) k_rmsnorm(const float* __restrict__ x, const float* __restrict__ g, float* __restrict__ y) {
    __shared__ float red[4];
    const size_t row = blockIdx.x;
    const float4 v = ((const float4*)(x + row * D_MODEL))[threadIdx.x];
    float s = v.x * v.x + v.y * v.y + v.z * v.z + v.w * v.w;
    s = block_sum_256(s, red);
    const float r = rsqrtf(s * (1.0f / D_MODEL) + RMS_EPS);
    const float4 gg = ((const float4*)g)[threadIdx.x];
    float4 o; o.x = v.x * r * gg.x; o.y = v.y * r * gg.y; o.z = v.z * r * gg.z; o.w = v.w * r * gg.w;
    ((float4*)(y + row * D_MODEL))[threadIdx.x] = o;
}
__global__ void __launch_bounds__(256) k_resid_norm(float* __restrict__ x, const float* __restrict__ f, const float* __restrict__ g, float scale) {
    __shared__ float red[4];
    const size_t row = blockIdx.x;
    const float4 v = ((const float4*)(f + row * D_MODEL))[threadIdx.x];
    float s = v.x * v.x + v.y * v.y + v.z * v.z + v.w * v.w;
    s = block_sum_256(s, red);
    const float r = rsqrtf(s * (1.0f / D_MODEL) + RMS_EPS) * scale;
    const float4 gg = ((const float4*)g)[threadIdx.x];
    float4 o = ((float4*)(x + row * D_MODEL))[threadIdx.x];
    o.x += v.x * r * gg.x; o.y += v.y * r * gg.y; o.z += v.z * r * gg.z; o.w += v.w * r * gg.w;
    ((float4*)(x + row * D_MODEL))[threadIdx.x] = o;
}

__global__ void __launch_bounds__(256) k_gemm_f32(const float* __restrict__ A, int lda, const float* __restrict__ B, int ldb,
                                                  float* __restrict__ C, int ldc, int M, int N, int K) {
    __shared__ float As[16][68];
    __shared__ float Bs[16][68];
    const int tid = threadIdx.x, tx = tid & 15, ty = tid >> 4;
    const int m0 = blockIdx.y * 64, n0 = blockIdx.x * 64;
    float acc[4][4];
#pragma unroll
    for (int i = 0; i < 4; ++i)
#pragma unroll
        for (int j = 0; j < 4; ++j) acc[i][j] = 0.f;
    for (int k0 = 0; k0 < K; k0 += 16) {
        {
            const int r = tid >> 2, c = (tid & 3) * 4;
            const float4 v = *(const float4*)(A + (size_t)(m0 + r) * lda + k0 + c);
            As[c + 0][r] = v.x; As[c + 1][r] = v.y; As[c + 2][r] = v.z; As[c + 3][r] = v.w;
        }
        {
            const int r = tid >> 4, c = (tid & 15) * 4;
#pragma unroll
            for (int j = 0; j < 4; ++j) Bs[r][c + j] = (n0 + c + j < N) ? B[(size_t)(k0 + r) * ldb + n0 + c + j] : 0.f;
        }
        __syncthreads();
#pragma unroll
        for (int kk = 0; kk < 16; ++kk) {
            float a[4], b[4];
#pragma unroll
            for (int i = 0; i < 4; ++i) a[i] = As[kk][ty * 4 + i];
#pragma unroll
            for (int j = 0; j < 4; ++j) b[j] = Bs[kk][tx * 4 + j];
#pragma unroll
            for (int i = 0; i < 4; ++i)
#pragma unroll
                for (int j = 0; j < 4; ++j) acc[i][j] = fmaf(a[i], b[j], acc[i][j]);
        }
        __syncthreads();
    }
#pragma unroll
    for (int i = 0; i < 4; ++i)
#pragma unroll
        for (int j = 0; j < 4; ++j) {
            const int n = n0 + tx * 4 + j;
            if (n < N) C[(size_t)(m0 + ty * 4 + i) * ldc + n] = acc[i][j];
        }
}

__device__ __forceinline__ float silu_f(float v) { return v / (1.0f + expf(-v)); }
__global__ void k_swiglu(const float* G, const float* U, float* H, size_t n) {
    const size_t i = (size_t)blockIdx.x * blockDim.x + threadIdx.x;
    if (i < n) H[i] = silu_f(G[i]) * U[i];
}

__global__ void k_kmean(const float* __restrict__ proj, float* __restrict__ kmean) {
    const int i = blockIdx.x * blockDim.x + threadIdx.x;
    if (i >= MOBA_H * NBLK * MOBA_DH) return;
    const int d = i % MOBA_DH, blk = (i / MOBA_DH) % NBLK, h = i / (MOBA_DH * NBLK);
    float s = 0.f;
    for (int t = 0; t < MOBA_BLK; ++t) s += proj[(size_t)(blk * MOBA_BLK + t) * IN_W + C_MK + h * MOBA_DH + d];
    kmean[i] = s * (1.0f / MOBA_BLK);
}

__global__ void __launch_bounds__(64) k_moba(const float* __restrict__ proj, const float* __restrict__ kmean, float* __restrict__ o_out) {
    const int i = blockIdx.x * blockDim.x + threadIdx.x;
    const int q = i % SEQ, h = i / SEQ;
    const int blk = q / MOBA_BLK;
    float qv[64];
    const float* qp = proj + (size_t)q * IN_W + C_MQ + h * MOBA_DH;
#pragma unroll
    for (int d = 0; d < 64; ++d) qv[d] = qp[d];
    float gate[NBLK];
#pragma unroll
    for (int j = 0; j < NBLK; ++j) {
        float s = 0.f;
        const float* km = kmean + (size_t)(h * NBLK + j) * MOBA_DH;
#pragma unroll
        for (int d = 0; d < 64; ++d) s = fmaf(qv[d], km[d], s);
        gate[j] = s;
    }
    unsigned selmask = 0;
#pragma unroll
    for (int j = 0; j < NBLK; ++j) {
        int rank = 0;
#pragma unroll
        for (int k = 0; k < NBLK; ++k) {
            if (k != j && k < blk) rank += (gate[k] > gate[j] || (gate[k] == gate[j] && k < j)) ? 1 : 0;
        }
        if (j < blk && rank < MOBA_TOPK) selmask |= 1u << j;
    }
    selmask |= 1u << blk;
    float m = -INFINITY, l = 0.f;
    float o[64];
#pragma unroll
    for (int d = 0; d < 64; ++d) o[d] = 0.f;
    for (int j = 0; j <= blk; ++j) {
        if (!((selmask >> j) & 1u)) continue;
        const int kend = (j == blk) ? (q - blk * MOBA_BLK + 1) : MOBA_BLK;
        for (int t = 0; t < kend; ++t) {
            const size_t row = (size_t)(j * MOBA_BLK + t);
            const float* kp = proj + row * IN_W + C_MK + h * MOBA_DH;
            const float* vp = proj + row * IN_W + C_MV + h * MOBA_DH;
            float s = 0.f;
#pragma unroll
            for (int d = 0; d < 64; ++d) s = fmaf(qv[d], kp[d], s);
            s *= 0.125f;
            const float mn = fmaxf(m, s);
            const float a = expf(m - mn), p = expf(s - mn);
            l = l * a + p;
#pragma unroll
            for (int d = 0; d < 64; ++d) o[d] = fmaf(p, vp[d], o[d] * a);
            m = mn;
        }
    }
    const float inv = 1.0f / l;
    float* op = o_out + (size_t)q * MOBA_W + h * MOBA_DH;
#pragma unroll
    for (int d = 0; d < 64; ++d) op[d] = o[d] * inv;
}

__global__ void k_gla_gate(const float* __restrict__ proj, const float* __restrict__ wup, const float* __restrict__ bal, float* __restrict__ alpha) {
    const int i = blockIdx.x * blockDim.x + threadIdx.x;
    if (i >= SEQ * GLA_KW) return;
    const int c = i % GLA_KW, t = i / GLA_KW;
    float z = bal[c];
    for (int r = 0; r < GLA_RANK; ++r) z = fmaf(proj[(size_t)t * IN_W + C_GA + r], wup[r * GLA_KW + c], z);
    const float ls = fminf(z, 0.f) - log1pf(expf(-fabsf(z)));
    alpha[i] = expf(ls * (1.0f / 16.0f));
}

__global__ void __launch_bounds__(128) k_gla(const float* __restrict__ proj, const float* __restrict__ alpha, float* __restrict__ o_out) {
    const int h = blockIdx.x, e = threadIdx.x;
    __shared__ float sq[64], sk[64], sa[64];
    float S[64];
#pragma unroll
    for (int d = 0; d < 64; ++d) S[d] = 0.f;
    for (int t = 0; t < SEQ; ++t) {
        __syncthreads();
        if (e < 64) {
            sq[e] = proj[(size_t)t * IN_W + C_GQ + h * GLA_DK + e] * 0.125f;
            sk[e] = proj[(size_t)t * IN_W + C_GK + h * GLA_DK + e];
            sa[e] = alpha[(size_t)t * GLA_KW + h * GLA_DK + e];
        }
        __syncthreads();
        const float v = proj[(size_t)t * IN_W + C_GV + h * GLA_DV + e];
        float o = 0.f;
#pragma unroll
        for (int d = 0; d < 64; ++d) { S[d] = fmaf(sa[d], S[d], sk[d] * v); o = fmaf(sq[d], S[d], o); }
        o_out[(size_t)t * GLA_VW + h * GLA_DV + e] = o;
    }
}

__global__ void __launch_bounds__(256) k_mix_prep(const float* __restrict__ omoba, const float* __restrict__ ogla, const float* __restrict__ proj,
                                                  const float* __restrict__ moba_g, const float* __restrict__ gla_g, float* __restrict__ A) {
    __shared__ float red[4];
    const size_t row = blockIdx.x; const int tid = threadIdx.x;
    const float a0 = omoba[row * MOBA_W + tid], a1 = omoba[row * MOBA_W + 256 + tid];
    float s = block_sum_256(a0 * a0 + a1 * a1, red);
    const float r = rsqrtf(s * (1.0f / MOBA_W) + RMS_EPS);
    A[row * D_MODEL + tid] = a0 * r * moba_g[tid];
    A[row * D_MODEL + 256 + tid] = a1 * r * moba_g[256 + tid];
    const float g0 = ogla[row * GLA_VW + tid], g1 = ogla[row * GLA_VW + 256 + tid];
    float s0 = g0 * g0, s1 = g1 * g1;
    for (int o = 32; o > 0; o >>= 1) { s0 += __shfl_xor(s0, o); s1 += __shfl_xor(s1, o); }
    __shared__ float hs[2][4];
    __syncthreads();
    if ((tid & 63) == 0) { hs[0][tid >> 6] = s0; hs[1][tid >> 6] = s1; }
    __syncthreads();
    const int hw = (tid >> 7) * 2;
    const float r0 = rsqrtf((hs[0][hw] + hs[0][hw + 1]) * (1.0f / GLA_DV) + RMS_EPS);
    const float r1 = rsqrtf((hs[1][hw] + hs[1][hw + 1]) * (1.0f / GLA_DV) + RMS_EPS);
    const float gr0 = proj[row * IN_W + C_GR + tid], gr1 = proj[row * IN_W + C_GR + 256 + tid];
    A[row * D_MODEL + 512 + tid] = g0 * r0 * gla_g[tid] * silu_f(gr0);
    A[row * D_MODEL + 768 + tid] = g1 * r1 * gla_g[256 + tid] * silu_f(gr1);
}

static void gemm(const float* A, int lda, const float* B, int ldb, float* C, int ldc, int M, int N, int K, hipStream_t s) {
    dim3 grid((N + 63) / 64, M / 64);
    hipLaunchKernelGGL(k_gemm_f32, grid, dim3(256), 0, s, A, lda, B, ldb, C, ldc, M, N, K);
}

extern "C" void kernel_launch(void* const* d_in, const int* in_sizes, int n_in, void* d_out, int out_size, void* d_ws, size_t ws_size, hipStream_t stream) {
    const float* x = (const float*)d_in[0];
    const float* f1_pre = (const float*)d_in[1]; const float* f1_wg = (const float*)d_in[2]; const float* f1_wu = (const float*)d_in[3];
    const float* f1_wd = (const float*)d_in[4]; const float* f1_post = (const float*)d_in[5];
    const float* mix_pre = (const float*)d_in[6]; const float* w_in = (const float*)d_in[7]; const float* wup = (const float*)d_in[8];
    const float* bal = (const float*)d_in[9]; const float* moba_g = (const float*)d_in[10]; const float* gla_g = (const float*)d_in[11];
    const float* w_out = (const float*)d_in[12]; const float* mix_post = (const float*)d_in[13];
    const float* f2_pre = (const float*)d_in[14]; const float* f2_wg = (const float*)d_in[15]; const float* f2_wu = (const float*)d_in[16];
    const float* f2_wd = (const float*)d_in[17]; const float* f2_post = (const float*)d_in[18];
    float* out = (float*)d_out;
    float* ws = (float*)d_ws;
    size_t off = 0;
    float* hn = ws + off;    off += (size_t)SEQ * D_MODEL;
    float* G = ws + off;     off += (size_t)SEQ * D_FF;
    float* U = ws + off;     off += (size_t)SEQ * D_FF;
    float* F = ws + off;     off += (size_t)SEQ * D_MODEL;
    float* proj = ws + off;  off += (size_t)SEQ * IN_W;
    float* kmean = ws + off; off += (size_t)MOBA_H * NBLK * MOBA_DH;
    float* alpha = ws + off; off += (size_t)SEQ * GLA_KW;
    float* omoba = ws + off; off += (size_t)SEQ * MOBA_W;
    float* ogla = ws + off;  off += (size_t)SEQ * GLA_VW;
    float* Amix = ws + off;  off += (size_t)SEQ * D_MODEL;
    if (off * 4 > ws_size) { fprintf(stderr, "workspace too small\n"); return; }

    hipMemcpyAsync(out, x, (size_t)BATCH * SEQ * D_MODEL * 4, hipMemcpyDeviceToDevice, stream);
    for (int b = 0; b < BATCH; ++b) {
        float* xb = out + (size_t)b * SEQ * D_MODEL;
        const size_t nff = (size_t)SEQ * D_FF;
        hipLaunchKernelGGL(k_rmsnorm, dim3(SEQ), dim3(256), 0, stream, xb, f1_pre, hn);
        gemm(hn, D_MODEL, f1_wg, D_FF, G, D_FF, SEQ, D_FF, D_MODEL, stream);
        gemm(hn, D_MODEL, f1_wu, D_FF, U, D_FF, SEQ, D_FF, D_MODEL, stream);
        hipLaunchKernelGGL(k_swiglu, dim3((unsigned)((nff + 255) / 256)), dim3(256), 0, stream, G, U, G, nff);
        gemm(G, D_FF, f1_wd, D_MODEL, F, D_MODEL, SEQ, D_MODEL, D_FF, stream);
        hipLaunchKernelGGL(k_resid_norm, dim3(SEQ), dim3(256), 0, stream, xb, F, f1_post, 0.5f);
        hipLaunchKernelGGL(k_rmsnorm, dim3(SEQ), dim3(256), 0, stream, xb, mix_pre, hn);
        gemm(hn, D_MODEL, w_in, IN_W, proj, IN_W, SEQ, IN_W, D_MODEL, stream);
        hipLaunchKernelGGL(k_kmean, dim3((MOBA_H * NBLK * MOBA_DH + 255) / 256), dim3(256), 0, stream, proj, kmean);
        hipLaunchKernelGGL(k_moba, dim3(MOBA_H * SEQ / 64), dim3(64), 0, stream, proj, kmean, omoba);
        hipLaunchKernelGGL(k_gla_gate, dim3(SEQ * GLA_KW / 256), dim3(256), 0, stream, proj, wup, bal, alpha);
        hipLaunchKernelGGL(k_gla, dim3(GLA_H), dim3(128), 0, stream, proj, alpha, ogla);
        hipLaunchKernelGGL(k_mix_prep, dim3(SEQ), dim3(256), 0, stream, omoba, ogla, proj, moba_g, gla_g, Amix);
        gemm(Amix, D_MODEL, w_out, D_MODEL, F, D_MODEL, SEQ, D_MODEL, D_MODEL, stream);
        hipLaunchKernelGGL(k_resid_norm, dim3(SEQ), dim3(256), 0, stream, xb, F, mix_post, 1.0f);
        hipLaunchKernelGGL(k_rmsnorm, dim3(SEQ), dim3(256), 0, stream, xb, f2_pre, hn);
        gemm(hn, D_MODEL, f2_wg, D_FF, G, D_FF, SEQ, D_FF, D_MODEL, stream);
        gemm(hn, D_MODEL, f2_wu, D_FF, U, D_FF, SEQ, D_FF, D_MODEL, stream);
        hipLaunchKernelGGL(k_swiglu, dim3((unsigned)((nff + 255) / 256)), dim3(256), 0, stream, G, U, G, nff);
        gemm(G, D_FF, f2_wd, D_MODEL, F, D_MODEL, SEQ, D_MODEL, D_FF, stream);
        hipLaunchKernelGGL(k_resid_norm, dim3(SEQ), dim3(256), 0, stream, xb, F, f2_post, 0.5f);
    }
}
```
